# Optimizing an MI355X kernel written in HIP

```python
import math
import jax, jax.numpy as jnp
from jax import lax
import numpy as np

D_MODEL = 2048
BATCH = 2
SEQ = 4096
DEPTH = 1

HEAD_DIM = 128
N_MOBA_HEADS = 8
N_FOX_HEADS = 8
MOBA_WIDTH = N_MOBA_HEADS * HEAD_DIM
FOX_WIDTH = N_FOX_HEADS * HEAD_DIM
MOBA_BLOCK = 256
MOBA_TOP_K = 3
MOBA_Q_CHUNK = 32
FOX_Q_BLOCK = 128
ROPE_THETA = 500000.0
ROPE_DIM = HEAD_DIM // 4
D_FF = 4 * D_MODEL
N_BRANCHES = 2
RMS_EPS = 1e-6
NEG_BIG = -1e30
IN_SPLITS = [MOBA_WIDTH, MOBA_WIDTH, MOBA_WIDTH, FOX_WIDTH, FOX_WIDTH, FOX_WIDTH, N_FOX_HEADS, D_MODEL, D_MODEL]
IN_COLS = sum(IN_SPLITS)

kernel_name = "hybrid_moba_fox_gated_block"


def rmsnorm(x, g):
    xf = x.astype(jnp.float32)
    y = xf * lax.rsqrt(jnp.mean(xf * xf, axis=-1, keepdims=True) + RMS_EPS)
    return (y * g.astype(jnp.float32)).astype(x.dtype)


def partial_rotary(t):
    S = t.shape[2]
    half = ROPE_DIM // 2
    inv_freq = ROPE_THETA ** (-jnp.arange(0, ROPE_DIM, 2, dtype=jnp.float32) / ROPE_DIM)
    ang = jnp.arange(S, dtype=jnp.float32)[:, None] * inv_freq[None, :]
    cos, sin = jnp.cos(ang), jnp.sin(ang)
    tf = t.astype(jnp.float32)
    x1, x2, rest = tf[..., :half], tf[..., half:ROPE_DIM], tf[..., ROPE_DIM:]
    out = jnp.concatenate([x1 * cos - x2 * sin, x2 * cos + x1 * sin, rest], axis=-1)
    return out.astype(t.dtype)


def split_heads(t, n_heads):
    B, S, _ = t.shape
    return t.reshape(B, S, n_heads, HEAD_DIM).transpose(0, 2, 1, 3)


def merge_heads(t):
    B, H, S, D = t.shape
    return t.transpose(0, 2, 1, 3).reshape(B, S, H * D)


def moba_attention(q, k, v):
    B, H, S, dh = q.shape
    nb = -(-S // MOBA_BLOCK)
    pad = nb * MOBA_BLOCK - S
    kp = jnp.pad(k, ((0, 0), (0, 0), (0, pad), (0, 0)))
    vp = jnp.pad(v, ((0, 0), (0, 0), (0, pad), (0, 0)))
    kb = kp.reshape(B, H, nb, MOBA_BLOCK, dh)
    vb = vp.reshape(B, H, nb, MOBA_BLOCK, dh)
    kmean = jnp.mean(kb.astype(jnp.float32), axis=3)
    n_sel = min(MOBA_TOP_K, nb)
    scale = dh ** -0.5
    n_chunks = S // MOBA_Q_CHUNK
    qc = q.reshape(B, H, n_chunks, MOBA_Q_CHUNK, dh).transpose(2, 0, 1, 3, 4)
    bi = jnp.arange(B)[:, None, None, None]
    hi = jnp.arange(H)[None, :, None, None]
    block_ids = jnp.arange(nb)
    own_offsets = jnp.arange(MOBA_BLOCK)

    def chunk_fn(args):
        c, qi = args
        q_pos = c * MOBA_Q_CHUNK + jnp.arange(MOBA_Q_CHUNK)
        blk = (c * MOBA_Q_CHUNK) // MOBA_BLOCK
        gate = jnp.einsum('bhqd,bhnd->bhqn', qi.astype(jnp.float32), kmean)
        gate = jnp.where(block_ids < blk, gate, -jnp.inf)
        _, idx = lax.top_k(gate, n_sel)
        sel_valid = idx < blk
        k_sel = kb[bi, hi, idx]
        v_sel = vb[bi, hi, idx]
        s_sel = jnp.einsum('bhqd,bhqnkd->bhqnk', qi, k_sel, preferred_element_type=jnp.float32) * scale
        s_sel = jnp.where(sel_valid[..., None], s_sel, NEG_BIG)
        k_own = lax.dynamic_index_in_dim(kb, blk, axis=2, keepdims=False)
        v_own = lax.dynamic_index_in_dim(vb, blk, axis=2, keepdims=False)
        s_own = jnp.einsum('bhqd,bhkd->bhqk', qi, k_own, preferred_element_type=jnp.float32) * scale
        key_pos = blk * MOBA_BLOCK + own_offsets
        s_own = jnp.where(key_pos[None, :] <= q_pos[:, None], s_own, NEG_BIG)
        logits = jnp.concatenate([s_sel.reshape(B, H, MOBA_Q_CHUNK, n_sel * MOBA_BLOCK), s_own], axis=-1)
        p = jax.nn.softmax(logits, axis=-1).astype(v.dtype)
        p_sel = p[..., :n_sel * MOBA_BLOCK].reshape(B, H, MOBA_Q_CHUNK, n_sel, MOBA_BLOCK)
        p_own = p[..., n_sel * MOBA_BLOCK:]
        return (jnp.einsum('bhqnk,bhqnkd->bhqd', p_sel, v_sel)
                + jnp.einsum('bhqk,bhkd->bhqd', p_own, v_own))

    out = lax.map(chunk_fn, (jnp.arange(n_chunks), qc))
    return out.transpose(1, 2, 0, 3, 4).reshape(B, H, S, dh)


def fox_attention(q, k, v, log_f):
    B, H, S, dh = q.shape
    F = jnp.cumsum(log_f, axis=-1)
    scale = dh ** -0.5
    n_blocks = S // FOX_Q_BLOCK
    qb = q.reshape(B, H, n_blocks, FOX_Q_BLOCK, dh).transpose(2, 0, 1, 3, 4)
    Fq = F.reshape(B, H, n_blocks, FOX_Q_BLOCK).transpose(2, 0, 1, 3)
    key_pos = jnp.arange(S)

    def block_fn(args):
        c, qi, fi = args
        q_pos = c * FOX_Q_BLOCK + jnp.arange(FOX_Q_BLOCK)
        s = jnp.einsum('bhqd,bhkd->bhqk', qi, k, preferred_element_type=jnp.float32) * scale
        s = s + fi[..., :, None] - F[:, :, None, :]
        s = jnp.where(key_pos[None, :] <= q_pos[:, None], s, NEG_BIG)
        p = jax.nn.softmax(s, axis=-1).astype(v.dtype)
        return jnp.einsum('bhqk,bhkd->bhqd', p, v)

    out = lax.map(block_fn, (jnp.arange(n_blocks), qb, Fq))
    return out.transpose(1, 2, 0, 3, 4).reshape(B, H, S, dh)


def setup_inputs(seed: int = 0) -> dict:
    key = jax.random.key(seed)
    ks = jax.random.split(key, 13)
    f32 = jnp.float32
    x = jax.random.normal(ks[0], (BATCH, SEQ, D_MODEL), f32)
    w_in = jax.random.normal(ks[1], (DEPTH, D_MODEL, IN_COLS), f32) * D_MODEL ** -0.5
    b_forget = 3.0 + 0.1 * jax.random.normal(ks[2], (DEPTH, N_FOX_HEADS), f32)
    w_branch_moba = jax.random.normal(ks[3], (DEPTH, MOBA_WIDTH, D_MODEL), f32) * MOBA_WIDTH ** -0.5
    w_branch_fox = jax.random.normal(ks[4], (DEPTH, FOX_WIDTH, D_MODEL), f32) * FOX_WIDTH ** -0.5
    w_out = jax.random.normal(ks[5], (DEPTH, D_MODEL, D_MODEL), f32) * D_MODEL ** -0.5
    g_mix_pre = 1.0 + 0.05 * jax.random.normal(ks[6], (DEPTH, D_MODEL), f32)
    g_mix_post = 1.0 + 0.05 * jax.random.normal(ks[7], (DEPTH, D_MODEL), f32)
    w_up = jax.random.normal(ks[8], (DEPTH, D_MODEL, D_FF), f32) * D_MODEL ** -0.5
    w_down = jax.random.normal(ks[9], (DEPTH, D_FF, D_MODEL), f32) * D_FF ** -0.5
    g_mlp_pre = 1.0 + 0.05 * jax.random.normal(ks[10], (DEPTH, D_MODEL), f32)
    g_mlp_post = 1.0 + 0.05 * jax.random.normal(ks[11], (DEPTH, D_MODEL), f32)
    return {"x": x, "w_in": w_in, "b_forget": b_forget, "w_branch_moba": w_branch_moba,
            "w_branch_fox": w_branch_fox, "w_out": w_out, "g_mix_pre": g_mix_pre,
            "g_mix_post": g_mix_post, "w_up": w_up, "w_down": w_down,
            "g_mlp_pre": g_mlp_pre, "g_mlp_post": g_mlp_post}


def reference(x, w_in, b_forget, w_branch_moba, w_branch_fox, w_out, g_mix_pre, g_mix_post,
              w_up, w_down, g_mlp_pre, g_mlp_post):
    split_points = list(np.cumsum(IN_SPLITS)[:-1])
    for l in range(DEPTH):
        h = rmsnorm(x, g_mix_pre[l])
        proj = jnp.einsum('bsd,dc->bsc', h, w_in[l])
        mq, mk, mv, fq, fk, fv, ff, ga, gb = jnp.split(proj, split_points, axis=-1)
        mq = partial_rotary(split_heads(mq, N_MOBA_HEADS))
        mk = partial_rotary(split_heads(mk, N_MOBA_HEADS))
        o_moba = merge_heads(moba_attention(mq, mk, split_heads(mv, N_MOBA_HEADS)))
        log_f = jax.nn.log_sigmoid((ff + b_forget[l]).astype(jnp.float32)).transpose(0, 2, 1)
        o_fox = merge_heads(fox_attention(split_heads(fq, N_FOX_HEADS), split_heads(fk, N_FOX_HEADS),
                                          split_heads(fv, N_FOX_HEADS), log_f))
        y_moba = jnp.einsum('bsc,cd->bsd', o_moba, w_branch_moba[l])
        y_fox = jnp.einsum('bsc,cd->bsd', o_fox, w_branch_fox[l])
        merged = jax.nn.sigmoid(ga) * y_moba + jax.nn.sigmoid(gb) * y_fox
        mixed = jnp.einsum('bsd,de->bse', merged, w_out[l])
        x = x + rmsnorm(mixed, g_mix_post[l])
        h = rmsnorm(x, g_mlp_pre[l])
        u = jnp.einsum('bsd,df->bsf', h, w_up[l])
        m = jnp.einsum('bsf,fd->bsd', jnp.square(jax.nn.relu(u)), w_down[l])
        x = x + rmsnorm(m, g_mlp_post[l])
    return x
```

```cpp
#include <hip/hip_runtime.h>
#include <cstdio>
#include <cstdint>

#define LAS __attribute__((address_space(3)))
#define GAS __attribute__((address_space(1)))
typedef _Float16 h16;
typedef _Float16 h16x8 __attribute__((ext_vector_type(8)));
typedef _Float16 h16x4 __attribute__((ext_vector_type(4)));
typedef _Float16 h16x2 __attribute__((ext_vector_type(2)));
typedef float f32x2 __attribute__((ext_vector_type(2)));
typedef float f32x4 __attribute__((ext_vector_type(4)));
typedef float f32x16 __attribute__((ext_vector_type(16)));
typedef unsigned u32x2 __attribute__((ext_vector_type(2)));
typedef unsigned u32x4 __attribute__((ext_vector_type(4)));
typedef short s16x4 __attribute__((ext_vector_type(4)));

#ifndef MK_N_LAUNCHES
#define MK_N_LAUNCHES 9
#endif

constexpr int BATCH = 2, SEQ = 4096, DM = 2048, T = BATCH * SEQ, HD = 128, NH = 8, FF = 8192;
constexpr int IN_COLS = 10248, NPROJ = 10240, FF_COL = 6144;
constexpr float RMS_EPS = 1e-6f;
constexpr float LOG2E = 1.4426950408889634f;
constexpr float QSCALE = 0.08838834764831845f * 1.4426950408889634f;

__device__ __forceinline__ unsigned pkh(float lo, float hi) { f32x2 v = {lo, hi}; h16x2 h = __builtin_convertvector(v, h16x2); return __builtin_bit_cast(unsigned, h); }

namespace pg8 {
constexpr int BM = 256, BK = 64, HALF = 128, HTB = HALF * BK * 2, STAGE_BYTES = 8 * HTB, NXCD = 8, WGM = 8;
__host__ __device__ __forceinline__ int lds_byte(int r, int c) { const int st = (r >> 4) * 2 + (c >> 5), rr = r & 15, cc = c & 31, ob = rr * 64 + cc * 2; return st * 1024 + (ob ^ (((ob >> 9) & 1) << 5)); }
__host__ __device__ __forceinline__ void stage_rc(int b, int& R, int& C) { const int st = b / 1024, sb = b % 1024, swz = sb ^ (((sb >> 9) & 1) << 5); R = (st >> 1) * 16 + swz / 64; C = (st & 1) * 32 + (swz % 64) / 2; }

struct Unit { int pm, pn, kh; };
struct Gemm { const h16* A; const h16* Bt; int lda, ldb, K; };

struct StaticOrder {
    int nM, nN, nwg, G, c;
    __device__ void init(int M, int N, int G_, int c_) { nM = M / BM; nN = N / BM; nwg = nM * nN; G = G_; c = c_; }
    __device__ bool next(int i, Unit& u) const {
        const long L = (long)i * G + c; if (L >= nwg) return false;
        int wgid = (int)L; { const int q = nwg / NXCD, r = nwg % NXCD, xcd = wgid % NXCD, off = wgid / NXCD; wgid = (xcd < r ? xcd * (q + 1) : r * (q + 1) + (xcd - r) * q) + off; }
        const int nig = WGM * nN, gid = wgid / nig, fm = gid * WGM, gsz = (nM - fm) < WGM ? (nM - fm) : WGM;
        u.pm = fm + ((wgid % nig) % gsz); u.pn = (wgid % nig) / gsz; u.kh = 0; return true;
    }
};
struct TwoPassOrder {
    StaticOrder so;
    __device__ bool next(int i, Unit& u) const { if (!so.next(i >> 1, u)) return false; u.kh = i & 1; return true; }
};

typedef f32x4 Acc[2][2][4][2];

template <class Epi, class Sched, bool ALIGN_EPI>
__device__ __forceinline__ void gemm_phase(LAS unsigned char* lds, const Gemm g, const Sched& S, const Epi& E) {
    const int tid = threadIdx.x, wid = __builtin_amdgcn_readfirstlane(tid >> 6), lane = tid & 63, wr = wid >> 2, wc = wid & 3, fr = lane & 15, fq = lane >> 4;
    const int nt = g.K / BK;
    unsigned voffA[2], voffB[2];
#pragma unroll
    for (int i = 0; i < 2; ++i) { int R, C; stage_rc(tid * 16 + i * 8192, R, C); voffA[i] = (unsigned)(R * g.lda + C) * 2u; voffB[i] = (unsigned)(R * g.ldb + C) * 2u; }
    const size_t kstep = (size_t)(BK * 2);
    const size_t hstepA = (size_t)HALF * g.lda * 2, hstepB = (size_t)HALF * g.ldb * 2, tstepA = 2 * hstepA, tstepB = 2 * hstepB, khstep = (size_t)g.K * 2;
    const unsigned ldsw = (unsigned)wid * 1024u;
    const int aoff = lds_byte(wr * 64 + fr, fq * 8), boff = lds_byte(wc * 32 + fr, fq * 8);
#define PG8_SA(b, h) (((b) * 2 + (h)) * HTB)
#define PG8_SB(b, h) ((4 + (b) * 2 + (h)) * HTB)
#define PG8_STAGE(bufoff, gbase, voff) do { _Pragma("unroll") for (int _i = 0; _i < 2; ++_i) \
        __builtin_amdgcn_global_load_lds((const unsigned*)((const char*)(gbase) + (voff)[_i]), (LAS unsigned*)(lds + (bufoff) + ldsw + _i * 8192), 16, 0, 0); } while (0)
#define PG8_LDA(dst, b, h) do { _Pragma("unroll") for (int m = 0; m < 4; ++m) _Pragma("unroll") for (int k = 0; k < 2; ++k) dst[m][k] = *(const LAS h16x8*)(lds + PG8_SA(b, h) + aoff + m * 2048 + k * 1024); } while (0)
#define PG8_LDB(dst, b, h) do { _Pragma("unroll") for (int n = 0; n < 2; ++n) _Pragma("unroll") for (int k = 0; k < 2; ++k) dst[n][k] = *(const LAS h16x8*)(lds + PG8_SB(b, h) + boff + n * 2048 + k * 1024); } while (0)
#define PG8_MMA(ai, bj, At, Bt) do { __builtin_amdgcn_s_setprio(1); _Pragma("unroll") for (int m = 0; m < 4; ++m) _Pragma("unroll") for (int n = 0; n < 2; ++n) _Pragma("unroll") for (int k = 0; k < 2; ++k) \
        acc[ai][bj][m][n] = __builtin_amdgcn_mfma_f32_16x16x32_f16(Bt[n][k], At[m][k], acc[ai][bj][m][n], 0, 0, 0); __builtin_amdgcn_s_setprio(0); } while (0)
#define PG8_WAIT_V(n) asm volatile("s_waitcnt vmcnt(" #n ")" ::: "memory")
#define PG8_WAIT_L(n) asm volatile("s_waitcnt lgkmcnt(" #n ")" ::: "memory")
#define PG8_BAR __builtin_amdgcn_s_barrier()
#define PG8_SCHED __builtin_amdgcn_sched_barrier(0)
    Unit cur, nxt; int ui = 0;
    if (!S.next(0, cur)) return;
    Acc acc;
#pragma unroll
    for (int a = 0; a < 2; ++a)
#pragma unroll
        for (int b = 0; b < 2; ++b)
#pragma unroll
            for (int m = 0; m < 4; ++m)
#pragma unroll
                for (int n = 0; n < 2; ++n) acc[a][b][m][n] = (f32x4){0.f, 0.f, 0.f, 0.f};
    h16x8 At[4][2], B0[2][2], B1[2][2];
    const char* cA = (const char*)g.A + (size_t)cur.pm * tstepA + (size_t)cur.kh * khstep; const char* cB = (const char*)g.Bt + (size_t)cur.pn * tstepB + (size_t)cur.kh * khstep;
    PG8_STAGE(PG8_SB(0, 0), cB, voffB); PG8_STAGE(PG8_SB(0, 1), cB + hstepB, voffB); PG8_STAGE(PG8_SA(0, 0), cA, voffA); PG8_STAGE(PG8_SA(0, 1), cA + hstepA, voffA);
    if (wr == 1) PG8_BAR;
    PG8_WAIT_V(2); PG8_BAR;
    PG8_STAGE(PG8_SB(1, 0), cB + kstep, voffB); PG8_STAGE(PG8_SA(1, 0), cA + kstep, voffA); PG8_STAGE(PG8_SB(1, 1), cB + hstepB + kstep, voffB);
    PG8_WAIT_V(6); PG8_BAR;
    for (;;) {
        const bool has_next = S.next(ui + 1, nxt);
        const char* nA = has_next ? (const char*)g.A + (size_t)nxt.pm * tstepA + (size_t)nxt.kh * khstep : cA; const char* nB = has_next ? (const char*)g.Bt + (size_t)nxt.pn * tstepB + (size_t)nxt.kh * khstep : cB;
        for (int t = 0; t < nt; t += 2) {
            const bool last = (t == nt - 2);
            const char* a1 = cA + (size_t)(t + 1) * kstep;
            const char* a2 = last ? nA : cA + (size_t)(t + 2) * kstep; const char* b2 = last ? nB : cB + (size_t)(t + 2) * kstep;
            const char* a3 = a2 + kstep; const char* b3 = b2 + kstep;
            PG8_LDB(B0, 0, 0); PG8_LDB(B1, 0, 1); PG8_SCHED; PG8_LDA(At, 0, 0); PG8_STAGE(PG8_SA(1, 1), a1 + hstepA, voffA);
            PG8_WAIT_V(8); PG8_WAIT_L(0); PG8_BAR; PG8_MMA(0, 0, At, B0); PG8_MMA(0, 1, At, B1); PG8_BAR; PG8_SCHED;
            PG8_LDA(At, 0, 1); PG8_STAGE(PG8_SB(0, 0), b2, voffB); PG8_STAGE(PG8_SB(0, 1), b2 + hstepB, voffB); PG8_STAGE(PG8_SA(0, 0), a2, voffA);
            PG8_WAIT_V(8); PG8_WAIT_L(0); PG8_BAR; PG8_MMA(1, 0, At, B0); PG8_MMA(1, 1, At, B1); PG8_BAR; PG8_SCHED;
            PG8_LDB(B0, 1, 0); PG8_LDB(B1, 1, 1); PG8_SCHED; PG8_LDA(At, 1, 0); PG8_STAGE(PG8_SA(0, 1), a2 + hstepA, voffA);
            PG8_WAIT_V(8); PG8_WAIT_L(0); PG8_BAR; PG8_MMA(0, 0, At, B0); PG8_MMA(0, 1, At, B1); PG8_BAR; PG8_SCHED;
            PG8_LDA(At, 1, 1); PG8_STAGE(PG8_SB(1, 0), b3, voffB); PG8_STAGE(PG8_SB(1, 1), b3 + hstepB, voffB); PG8_STAGE(PG8_SA(1, 0), a3, voffA);
            PG8_WAIT_V(8); PG8_WAIT_L(0); PG8_BAR; PG8_MMA(1, 0, At, B0); PG8_MMA(1, 1, At, B1); PG8_BAR; PG8_SCHED;
        }
        if constexpr (ALIGN_EPI) { if (wr == 0) PG8_BAR; }
        E(acc, cur, wr, wc, fr, fq);
        if (!has_next) break;
        if (E.zero_after(cur)) {
#pragma unroll
            for (int a = 0; a < 2; ++a)
#pragma unroll
                for (int b = 0; b < 2; ++b)
#pragma unroll
                    for (int m = 0; m < 4; ++m)
#pragma unroll
                        for (int n = 0; n < 2; ++n) acc[a][b][m][n] = (f32x4){0.f, 0.f, 0.f, 0.f};
        }
        cur = nxt; cA = nA; cB = nB; ++ui;
        if constexpr (ALIGN_EPI) { if (wr == 1) PG8_BAR; }
    }
    PG8_WAIT_V(0);
    if constexpr (!ALIGN_EPI) { if (wr == 0) PG8_BAR; }
    PG8_BAR;
#undef PG8_SA
#undef PG8_SB
#undef PG8_STAGE
#undef PG8_LDA
#undef PG8_LDB
#undef PG8_MMA
#undef PG8_WAIT_V
#undef PG8_WAIT_L
#undef PG8_BAR
#undef PG8_SCHED
}

struct EpiProj {
    h16* qkv; h16* sg; float* ksum; const float* rcos; const float* rsin;
    __device__ __forceinline__ bool zero_after(const Unit&) const { return true; }
    __device__ __forceinline__ void operator()(Acc& acc, const Unit& u, int wr, int wc, int fr, int fq) const {
        if (u.pn < 24) {
            const int tix = u.pn >> 2, hp = u.pn & 3, b = u.pm >> 4, s0 = (u.pm & 15) * 256 + wr * 64 + fr;
            if ((tix == 0 || tix == 1) && wc == 0) {
#pragma unroll
                for (int ai = 0; ai < 2; ++ai)
#pragma unroll
                    for (int m = 0; m < 4; ++m) { const int s = s0 + ai * HALF + m * 16;
                        const f32x4 c4 = *(const f32x4*)(rcos + s * 16 + 4 * fq), s4 = *(const f32x4*)(rsin + s * 16 + 4 * fq);
#pragma unroll
                        for (int bj = 0; bj < 2; ++bj) { const f32x4 x1 = acc[ai][bj][m][0], x2 = acc[ai][bj][m][1]; acc[ai][bj][m][0] = x1 * c4 - x2 * s4; acc[ai][bj][m][1] = x2 * c4 + x1 * s4; } }
            }
            if (tix == 1) {
#pragma unroll
                for (int bj = 0; bj < 2; ++bj)
#pragma unroll
                    for (int n = 0; n < 2; ++n) { f32x4 cs = (f32x4){0.f, 0.f, 0.f, 0.f};
#pragma unroll
                        for (int ai = 0; ai < 2; ++ai)
#pragma unroll
                            for (int m = 0; m < 4; ++m) cs += acc[ai][bj][m][n];
#pragma unroll
                        for (int o = 1; o < 16; o <<= 1) { cs[0] += __shfl_xor(cs[0], o); cs[1] += __shfl_xor(cs[1], o); cs[2] += __shfl_xor(cs[2], o); cs[3] += __shfl_xor(cs[3], o); }
                        if (fr == 0) { float* dst = ksum + (size_t)u.pm * 1024 + (hp * 2 + bj) * HD + wc * 32 + n * 16 + 4 * fq;
                            atomicAdd(dst + 0, cs[0]); atomicAdd(dst + 1, cs[1]); atomicAdd(dst + 2, cs[2]); atomicAdd(dst + 3, cs[3]); } }
            }
            const float sc = (tix == 0 || tix == 3) ? QSCALE : 1.f;
            h16* base = qkv + (size_t)tix * T * 1024;
#pragma unroll
            for (int ai = 0; ai < 2; ++ai)
#pragma unroll
                for (int m = 0; m < 4; ++m) { const int s = s0 + ai * HALF + m * 16;
#pragma unroll
                    for (int bj = 0; bj < 2; ++bj) { h16* rowp = base + ((size_t)(b * NH + hp * 2 + bj) * SEQ + s) * HD + wc * 32 + 4 * fq;
#pragma unroll
                        for (int n = 0; n < 2; ++n) { const f32x4 v = acc[ai][bj][m][n] * sc; u32x2 w; w.x = pkh(v[0], v[1]); w.y = pkh(v[2], v[3]); *(u32x2*)(rowp + n * 16) = w; } } }
        } else {
            const int gi = (u.pn - 24) >> 3, ct = (u.pn - 24) & 7;
            h16* base = sg + (size_t)gi * T * DM + (size_t)(u.pm * BM + wr * 64 + fr) * DM + ct * 256 + wc * 32 + 4 * fq;
#pragma unroll
            for (int ai = 0; ai < 2; ++ai)
#pragma unroll
                for (int m = 0; m < 4; ++m)
#pragma unroll
                    for (int bj = 0; bj < 2; ++bj)
#pragma unroll
                        for (int n = 0; n < 2; ++n) { const f32x4 x = acc[ai][bj][m][n]; f32x4 v;
#pragma unroll
                            for (int j = 0; j < 4; ++j) v[j] = __builtin_amdgcn_rcpf(1.f + __builtin_amdgcn_exp2f(-x[j] * LOG2E));
                            u32x2 w; w.x = pkh(v[0], v[1]); w.y = pkh(v[2], v[3]); *(u32x2*)(base + (size_t)(ai * HALF + m * 16) * DM + bj * HALF + n * 16) = w; }
        }
    }
};
struct EpiMerge {
    const h16* sga; const h16* sgb; h16* out;
    __device__ __forceinline__ bool zero_after(const Unit& u) const { return u.kh != 0; }
    __device__ __forceinline__ void operator()(Acc& acc, const Unit& u, int wr, int wc, int fr, int fq) const {
        const size_t off0 = (size_t)(u.pm * BM + wr * 64 + fr) * DM + u.pn * BM + wc * 32 + 4 * fq;
#pragma unroll
        for (int ai = 0; ai < 2; ++ai)
#pragma unroll
            for (int m = 0; m < 4; ++m)
#pragma unroll
                for (int bj = 0; bj < 2; ++bj)
#pragma unroll
                    for (int n = 0; n < 2; ++n) { const size_t off = off0 + (size_t)(ai * HALF + m * 16) * DM + bj * HALF + n * 16;
                        const h16x4 gb4 = *(const h16x4*)(sgb + off); const f32x4 gb = __builtin_convertvector(gb4, f32x4);
                        if (u.kh == 0) { const h16x4 ga4 = *(const h16x4*)(sga + off); const f32x4 ga = __builtin_convertvector(ga4, f32x4);
#pragma unroll
                            for (int j = 0; j < 4; ++j) acc[ai][bj][m][n][j] *= ga[j] * __builtin_amdgcn_rcpf(gb[j]); }
                        else { const f32x4 v = acc[ai][bj][m][n] * gb; u32x2 w; w.x = pkh(v[0], v[1]); w.y = pkh(v[2], v[3]); *(u32x2*)(out + off) = w; } }
    }
};
struct EpiF32 {
    float* C; int ldc;
    __device__ __forceinline__ bool zero_after(const Unit&) const { return true; }
    __device__ __forceinline__ void operator()(Acc& acc, const Unit& u, int wr, int wc, int fr, int fq) const {
        float* base = C + (size_t)(u.pm * BM + wr * 64 + fr) * ldc + u.pn * BM + wc * 32 + 4 * fq;
#pragma unroll
        for (int ai = 0; ai < 2; ++ai)
#pragma unroll
            for (int m = 0; m < 4; ++m)
#pragma unroll
                for (int bj = 0; bj < 2; ++bj)
#pragma unroll
                    for (int n = 0; n < 2; ++n) *(f32x4*)(base + (size_t)(ai * HALF + m * 16) * ldc + bj * HALF + n * 16) = acc[ai][bj][m][n];
    }
};
struct EpiRelu2 {
    h16* O; int ldc;
    __device__ __forceinline__ bool zero_after(const Unit&) const { return true; }
    __device__ __forceinline__ void operator()(Acc& acc, const Unit& u, int wr, int wc, int fr, int fq) const {
        h16* base = O + (size_t)(u.pm * BM + wr * 64 + fr) * ldc + u.pn * BM + wc * 32 + 4 * fq;
#pragma unroll
        for (int ai = 0; ai < 2; ++ai)
#pragma unroll
            for (int m = 0; m < 4; ++m)
#pragma unroll
                for (int bj = 0; bj < 2; ++bj)
#pragma unroll
                    for (int n = 0; n < 2; ++n) { f32x4 v = acc[ai][bj][m][n];
#pragma unroll
                        for (int j = 0; j < 4; ++j) { const float r = fmaxf(v[j], 0.f); v[j] = r * r; }
                        u32x2 w; w.x = pkh(v[0], v[1]); w.y = pkh(v[2], v[3]); *(u32x2*)(base + (size_t)(ai * HALF + m * 16) * ldc + bj * HALF + n * 16) = w; }
    }
};
}

namespace att {
constexpr int NW = 8, QBLK = 32, KVBLK = 64, QB = NW * QBLK, D = 128;
constexpr int SHM_V = KVBLK * D * 2, SHM_K = KVBLK * D * 2;
constexpr int OFF_V = 0, OFF_K = 2 * SHM_V, OFF_WS = 2 * SHM_V + 2 * SHM_K, OFF_NG = OFF_WS + NW * 64 * 4, OFF_SEL = OFF_NG + 4096 * 4, OFF_KM = OFF_SEL + 2 * 256 * 4, LDS_END = OFF_KM + 16 * 128 * 4;
constexpr unsigned KV_DIST = (unsigned)T * 1024u * 2u;
constexpr float THR2 = 10.f;
#define KSWZ(row, colB) ((row) * 256 + ((colB) ^ (((row) & 7) << 4)))
#define SBAR() __builtin_amdgcn_sched_barrier(0)
__device__ __forceinline__ int v_st(int k, int c) { const int kk = (k & ~0xC) | ((k & 4) << 1) | ((k & 8) >> 1); return ((kk >> 3) * 4 + (c >> 5)) * 512 + ((kk & 7) * 32 + (c & 31)) * 2; }
__device__ __forceinline__ int v_rd_base(int lane) { return ((lane & 3) << 3) | (((lane >> 2) & 3) << 6) | (((lane >> 4) & 1) << 5) | (((lane >> 5) & 1) << 8); }
constexpr int v_rd_off(int d0, int ks, int half) { return d0 * 512 + ks * 4096 + half * 2048; }
__device__ __forceinline__ int crow(int r, int hi) { return (r & 3) + 8 * (r >> 2) + 4 * hi; }
__device__ __forceinline__ h16x8 ld8(const h16* p) { return *reinterpret_cast<const h16x8*>(p); }
__device__ __forceinline__ void mask_tile(f32x16& p0, f32x16& p1, int dq) {
    const float NEG = -__builtin_inff();
#pragma unroll
    for (int r = 0; r < 16; ++r) { const int c = (r & 3) + 8 * (r >> 2); if (dq - c < 0) p0[r] = NEG; if (dq - c - 32 < 0) p1[r] = NEG; }
}
__device__ __forceinline__ void partialSM(f32x16& p0, f32x16& p1, float& m_reg, float& mn, float& alpha) {
    float pmax = p0[0];
#pragma unroll
    for (int r = 1; r < 16; ++r) pmax = fmaxf(pmax, p0[r]);
#pragma unroll
    for (int r = 0; r < 16; ++r) pmax = fmaxf(pmax, p1[r]);
    { auto rr = __builtin_amdgcn_permlane32_swap(__float_as_uint(pmax), __float_as_uint(pmax), false, false); pmax = fmaxf(__uint_as_float(rr[0]), __uint_as_float(rr[1])); }
    if (__builtin_expect(__all(pmax - m_reg <= THR2), 1)) { mn = m_reg; alpha = 1.f; }
    else { mn = fmaxf(m_reg, pmax); alpha = __builtin_amdgcn_exp2f(m_reg - mn); m_reg = mn; }
#pragma unroll
    for (int r = 0; r < 16; ++r) p0[r] = p0[r] - mn;
#pragma unroll
    for (int r = 0; r < 16; ++r) p1[r] = p1[r] - mn;
#pragma unroll
    for (int r = 0; r < 16; ++r) p0[r] = __builtin_amdgcn_exp2f(p0[r]);
}
__device__ __forceinline__ void finishSM(f32x16& p0, f32x16& p1, float alpha, float& l_reg, h16x8& pa0, h16x8& pa1, h16x8& pa2, h16x8& pa3) {
#pragma unroll
    for (int r = 0; r < 16; ++r) p1[r] = __builtin_amdgcn_exp2f(p1[r]);
    float ps = 0;
#pragma unroll
    for (int r = 0; r < 16; ++r) ps += p0[r];
#pragma unroll
    for (int r = 0; r < 16; ++r) ps += p1[r];
    { auto rr = __builtin_amdgcn_permlane32_swap(__float_as_uint(ps), __float_as_uint(ps), false, false); ps = __uint_as_float(rr[0]) + __uint_as_float(rr[1]); }
    l_reg = l_reg * alpha + ps;
#define PK4(P, B_, OUT) do { unsigned a0 = pkh(P[B_+0], P[B_+1]), a1 = pkh(P[B_+2], P[B_+3]); unsigned b0 = pkh(P[B_+4], P[B_+5]), b1 = pkh(P[B_+6], P[B_+7]); \
        auto r0 = __builtin_amdgcn_permlane32_swap(a0, b0, false, false); auto r1 = __builtin_amdgcn_permlane32_swap(a1, b1, false, false); \
        u32x4 w = {r0[0], r1[0], r0[1], r1[1]}; OUT = __builtin_bit_cast(h16x8, w); } while (0)
    PK4(p0, 0, pa0); PK4(p0, 8, pa1); PK4(p1, 0, pa2); PK4(p1, 8, pa3);
#undef PK4
}
template <int KB, int MODE>
__device__ __forceinline__ void qkt(f32x16& p0, f32x16& p1, const char* lds, int r32, int hi, const h16x8* qr, float cinit, int kbase) {
    if (MODE == 1) { const float* ng = (const float*)(lds + OFF_NG) + kbase + 4 * hi;
#pragma unroll
        for (int g = 0; g < 4; ++g) { const f32x4 a = *(const f32x4*)(ng + 8 * g), b = *(const f32x4*)(ng + 32 + 8 * g);
            p0[4 * g] = a[0]; p0[4 * g + 1] = a[1]; p0[4 * g + 2] = a[2]; p0[4 * g + 3] = a[3]; p1[4 * g] = b[0]; p1[4 * g + 1] = b[1]; p1[4 * g + 2] = b[2]; p1[4 * g + 3] = b[3]; } }
    else {
#pragma unroll
        for (int r = 0; r < 16; ++r) { p0[r] = cinit; p1[r] = cinit; } }
    const char* K_lds = lds + OFF_K;
    const char* kb[4];
#pragma unroll
    for (int dd = 0; dd < 4; ++dd) kb[dd] = K_lds + KB * SHM_K + KSWZ(r32, (dd * 16 + hi * 8) * 2);
#pragma unroll
    for (int d0 = 0; d0 < 8; ++d0) { const char* a = kb[d0 & 3] + (d0 >> 2) * 128;
        const h16x8 b0 = *reinterpret_cast<const h16x8*>(a);
        const h16x8 b1 = *reinterpret_cast<const h16x8*>(a + 32 * 256);
        p0 = __builtin_amdgcn_mfma_f32_32x32x16_f16(b0, qr[d0], p0, 0, 0, 0);
        p1 = __builtin_amdgcn_mfma_f32_32x32x16_f16(b1, qr[d0], p1, 0, 0, 0); }
}
template <int VB>
__device__ __forceinline__ void pv_tile(f32x16* o, int vb0, h16x8 pa0, h16x8 pa1, h16x8 pa2, h16x8 pa3) {
#define TRRD(dst, off) asm volatile("ds_read_b64_tr_b16 %0, %1 offset:%2" : "=&v"(dst) : "v"(vb0), "i"(off) : "memory")
#define HV(l, h) __builtin_bit_cast(h16x8, (u32x4){__builtin_bit_cast(u32x2, l).x, __builtin_bit_cast(u32x2, l).y, __builtin_bit_cast(u32x2, h).x, __builtin_bit_cast(u32x2, h).y})
#define PV_D0(d0) do { s16x4 l0, l1, l2, l3, h0, h1, h2, h3; constexpr int b_ = OFF_V + VB * SHM_V + v_rd_off(d0, 0, 0); \
        TRRD(l0, b_); TRRD(h0, b_ + 2048); TRRD(l1, b_ + 4096); TRRD(h1, b_ + 6144); TRRD(l2, b_ + 8192); TRRD(h2, b_ + 10240); TRRD(l3, b_ + 12288); TRRD(h3, b_ + 14336); \
        asm volatile("s_waitcnt lgkmcnt(0)" ::: "memory"); SBAR(); \
        o[d0] = __builtin_amdgcn_mfma_f32_32x32x16_f16(pa0, HV(l0, h0), o[d0], 0, 0, 0); \
        o[d0] = __builtin_amdgcn_mfma_f32_32x32x16_f16(pa1, HV(l1, h1), o[d0], 0, 0, 0); \
        o[d0] = __builtin_amdgcn_mfma_f32_32x32x16_f16(pa2, HV(l2, h2), o[d0], 0, 0, 0); \
        o[d0] = __builtin_amdgcn_mfma_f32_32x32x16_f16(pa3, HV(l3, h3), o[d0], 0, 0, 0); } while (0)
    PV_D0(0); PV_D0(1); PV_D0(2); PV_D0(3);
#undef PV_D0
#undef HV
#undef TRRD
}

struct HeadRef { const h16* Q; const h16* K; const h16* V; h16* O; const float* NG; };
struct Seam { h16x8 qr[8]; h16x8 st_v0, st_v1, st_k0, st_k1; };
#define ROW(p, k0, rr) ((p) + (size_t)((k0) + (rr)) * D + sc)
#define VMW() asm volatile("s_waitcnt vmcnt(0)" ::: "memory")
#define VMWN(n) asm volatile("s_waitcnt vmcnt(%0)" :: "i"(n) : "memory")
#define BLD(so) __builtin_bit_cast(h16x8, __builtin_amdgcn_raw_buffer_load_b128(kvrs, kvoff, (int)(so), 0))
#define SLOAD_H(k0) do { const unsigned so_ = (unsigned)(k0) * 256u; S.st_v0 = BLD(so_ + KV_DIST); S.st_v1 = BLD(so_ + KV_DIST + 8192u); S.st_k0 = BLD(so_); S.st_k1 = BLD(so_ + 8192u); } while (0)
#define SWRITE_HK(bf) do { *(h16x8*)(K_lds + (bf) * SHM_K + kws) = S.st_k0; *(h16x8*)(K_lds + (bf) * SHM_K + kws + 32 * 256) = S.st_k1; } while (0)
#define SWRITE_HV(bf) do { *(h16x8*)(V_lds + (bf) * SHM_V + vst0) = S.st_v0; *(h16x8*)(V_lds + (bf) * SHM_V + vst1) = S.st_v1; } while (0)
#define SWRITE_H(bf) do { SWRITE_HV(bf); SWRITE_HK(bf); } while (0)
template <int MODE>
__device__ __forceinline__ void attn_prime(const HeadRef& hd, const int P0, char* lds, Seam& S) {
    const int tid = threadIdx.x, wid = __builtin_amdgcn_readfirstlane(tid >> 6), lane = tid & 63, r32 = lane & 31, hi = lane >> 5;
    const int sr = tid >> 4, sc = (tid & 15) * 8, kws = KSWZ(sr, sc * 2); char* K_lds = lds + OFF_K;
    const int kb0 = MODE == 1 ? P0 + QB - KVBLK : 0;
#pragma unroll
    for (int d0 = 0; d0 < 8; ++d0) S.qr[d0] = ld8(hd.Q + (size_t)(P0 + wid * QBLK + r32) * D + d0 * 16 + hi * 8);
    const __amdgpu_buffer_rsrc_t kvrs = __builtin_amdgcn_make_buffer_rsrc((void*)hd.K, 0, (int)(KV_DIST + SEQ * D * 2), 0x00020000); const int kvoff = (sr * D + sc) * 2;
    SLOAD_H(kb0); VMW(); SWRITE_HK(0);
    __syncthreads();
}
template <int MODE>
__device__ __forceinline__ void attn_block(const HeadRef& hd, const int P0, const int P0n, const unsigned selm, char* lds, Seam& S) {
    const int tid = threadIdx.x, wid = __builtin_amdgcn_readfirstlane(tid >> 6), lane = tid & 63, r32 = lane & 31, hi = lane >> 5;
    const int NT = (P0 + QB) / KVBLK, qblk = P0 >> 8;
    const int kbn = MODE == 1 ? P0n + QB - KVBLK : 0;
    const int qlo = P0 + wid * QBLK, qm = qlo + r32 - 4 * hi;
    char* V_lds = lds + OFF_V; char* K_lds = lds + OFF_K;
    float* ws = (float*)(lds + OFF_WS) + wid * 64; float* li_l = ws, * al_l = ws + 32;
    float m_reg = -1e30f, l_reg = 0; f32x16 o[4] = {};
    const int sr = tid >> 4, sc = (tid & 15) * 8, vst0 = v_st(sr, sc), vst1 = v_st(32 + sr, sc), kws = KSWZ(sr, sc * 2);
    const int vb0 = (int)(uintptr_t)lds + v_rd_base(lane);
    const __amdgpu_buffer_rsrc_t kvrs = __builtin_amdgcn_make_buffer_rsrc((void*)hd.K, 0, (int)(KV_DIST + SEQ * D * 2), 0x00020000); const int kvoff = (sr * D + sc) * 2;
    const float NEGINF = -__builtin_inff();
#define RESC(a) do { if (__any((a) < 1.f)) { if (hi == 0) al_l[r32] = (a); asm volatile("s_waitcnt lgkmcnt(0)" ::: "memory"); \
                     _Pragma("unroll") for (int d_ = 0; d_ < 4; ++d_) _Pragma("unroll") for (int r = 0; r < 16; ++r) o[d_][r] *= al_l[crow(r, hi)]; } } while (0)
#define KBASE(t) (MODE == 1 ? (NT - 1 - (t)) * KVBLK : (t) * KVBLK)
#define CINIT(t) (MODE == 1 ? 0.f : ((((KBASE(t)) >> 8) == qblk || ((selm >> ((KBASE(t)) >> 8)) & 1u)) ? 0.f : NEGINF))
#define MASKT(P0_, P1_, t) do { const int kb_ = KBASE(t); if (kb_ + KVBLK - 1 > qlo) mask_tile(P0_, P1_, qm - kb_); } while (0)
    constexpr int NQL = 8;
#define SEAM_K0() do { VMWN(NQL); SWRITE_HK(0); SBAR(); } while (0)
    f32x16 pA0, pA1, pB0, pB1; float mnA, mnB, alA, alB; h16x8 pa0, pa1, pa2, pa3;
    SWRITE_HV(0); SBAR();
    if (NT > 1) { SLOAD_H(KBASE(1)); }
    SBAR(); qkt<0, MODE>(pA0, pA1, lds, r32, hi, S.qr, CINIT(0), KBASE(0));
    MASKT(pA0, pA1, 0); partialSM(pA0, pA1, m_reg, mnA, alA);
    if (NT > 1) { VMW(); SWRITE_H(1); }
    __syncthreads();
#define HALF_STEP(PX0, PX1, mnX, alX, PY0, PY1, alY, t, KB, VB, SB) do { \
        SBAR(); qkt<KB, MODE>(PX0, PX1, lds, r32, hi, S.qr, CINIT(t), KBASE(t)); \
        finishSM(PY0, PY1, alY, l_reg, pa0, pa1, pa2, pa3); SBAR(); \
        if ((t) + 1 < NT) { SLOAD_H(KBASE((t) + 1)); SBAR(); } \
        pv_tile<VB>(o, vb0, pa0, pa1, pa2, pa3); MASKT(PX0, PX1, (t)); partialSM(PX0, PX1, m_reg, mnX, alX); \
        __syncthreads(); \
        if ((t) + 1 < NT) { VMW(); SWRITE_H(SB); } \
        RESC(alX); __syncthreads(); } while (0)
    for (int t = 1; t + 1 < NT; t += 2) {
        HALF_STEP(pB0, pB1, mnB, alB, pA0, pA1, alA, t, 1, 0, 0);
        HALF_STEP(pA0, pA1, mnA, alA, pB0, pB1, alB, t + 1, 0, 1, 1);
    }
    const bool even = (NT & 1) == 0;
    if (even) { SBAR(); qkt<1, MODE>(pB0, pB1, lds, r32, hi, S.qr, CINIT(NT - 1), KBASE(NT - 1)); SBAR(); }
    SLOAD_H(kbn); SBAR();
#pragma unroll
    for (int d0 = 0; d0 < 8; ++d0) S.qr[d0] = ld8(hd.Q + (size_t)(P0n + wid * QBLK + r32) * D + d0 * 16 + hi * 8);
    SBAR();
    finishSM(pA0, pA1, alA, l_reg, pa0, pa1, pa2, pa3); SBAR();
    pv_tile<0>(o, vb0, pa0, pa1, pa2, pa3);
    if (even) { MASKT(pB0, pB1, NT - 1); partialSM(pB0, pB1, m_reg, mnB, alB); __syncthreads(); RESC(alB);
        finishSM(pB0, pB1, alB, l_reg, pa0, pa1, pa2, pa3); SBAR(); pv_tile<1>(o, vb0, pa0, pa1, pa2, pa3); }
    SBAR(); SEAM_K0();
    if (hi == 0) li_l[r32] = l_reg; asm volatile("s_waitcnt lgkmcnt(0)" ::: "memory");
    float rli[16];
#pragma unroll
    for (int r = 0; r < 16; ++r) rli[r] = __builtin_amdgcn_rcpf(li_l[crow(r, hi)]);
    h16* Ow = hd.O + (size_t)(P0 + wid * QBLK) * DM;
#pragma unroll
    for (int r = 0; r < 16; ++r) { const int orow = crow(r, hi);
#pragma unroll
        for (int d0 = 0; d0 < 4; ++d0) { const float v = o[d0][r] * rli[r]; const float vn = __shfl_xor(v, 1);
            if ((r32 & 1) == 0) *(unsigned*)(Ow + (size_t)orow * DM + d0 * 32 + r32) = pkh(v, vn); } }
    __syncthreads();
#undef RESC
#undef KBASE
#undef CINIT
#undef MASKT
#undef SEAM_K0
#undef HALF_STEP
}
#undef ROW
#undef VMW
#undef VMWN
#undef SLOAD_H
#undef BLD
#undef SWRITE_HK
#undef SWRITE_HV
#undef SWRITE_H

__device__ __forceinline__ void moba_select(const h16* Qh, const float* ksum_bh  , int qb0, int qb1, char* lds) {
    const int tid = threadIdx.x;
    float* km = (float*)(lds + OFF_KM); unsigned* sel = (unsigned*)(lds + OFF_SEL);
    for (int idx = tid; idx < 16 * 128; idx += 512) km[idx] = ksum_bh[(size_t)(idx >> 7) * 1024 + (idx & 127)];
    __syncthreads();
    const int u = __builtin_amdgcn_readfirstlane(tid >> 8), row = tid & 255, qb = u ? qb1 : qb0;
    const h16* qrow = Qh + (size_t)(qb * QB + row) * D;
    float g[15];
#pragma unroll
    for (int n = 0; n < 15; ++n) g[n] = 0.f;
#pragma unroll 2
    for (int c = 0; c < 16; ++c) { const h16x8 qv = ld8(qrow + 8 * c); float qf[8];
#pragma unroll
        for (int j = 0; j < 8; ++j) qf[j] = (float)qv[j];
#pragma unroll
        for (int n = 0; n < 15; ++n) if (n < qb) { const f32x4 k0 = *(const f32x4*)(km + n * 128 + 8 * c), k1 = *(const f32x4*)(km + n * 128 + 8 * c + 4);
            g[n] += (qf[0] * k0[0] + qf[1] * k0[1]) + (qf[2] * k0[2] + qf[3] * k0[3]) + (qf[4] * k1[0] + qf[5] * k1[1]) + (qf[6] * k1[2] + qf[7] * k1[3]); } }
    unsigned mask = 0;
#pragma unroll
    for (int n = 0; n < 15; ++n) if (n < qb) { int cnt = 0;
#pragma unroll
        for (int m = 0; m < 15; ++m) if (m != n && m < qb) cnt += (g[m] > g[n] || (g[m] == g[n] && m < n)) ? 1 : 0;
        if (cnt < 3) mask |= 1u << n; }
    sel[u * 256 + row] = mask;
    __syncthreads();
}
template <int MODE>
__device__ __forceinline__ void attn_item(const int item, const h16* QKV, h16* OCAT, const float* KSUM, const float* NG, char* lds) {
    const int tid = threadIdx.x, lane = tid & 63, wave = __builtin_amdgcn_readfirstlane(tid >> 6);
    const int bh = (item >> 3) & 15, s = item & 7, qb0 = s, qb1 = 15 - s;
    HeadRef hd;
    hd.Q = QKV + (size_t)(MODE * 3 + 0) * T * 1024 + (size_t)bh * SEQ * HD;
    hd.K = QKV + (size_t)(MODE * 3 + 1) * T * 1024 + (size_t)bh * SEQ * HD;
    hd.V = QKV + (size_t)(MODE * 3 + 2) * T * 1024 + (size_t)bh * SEQ * HD;
    hd.O = OCAT + (size_t)((bh >> 3) * SEQ) * DM + MODE * 1024 + (bh & 7) * HD;
    hd.NG = NG + (size_t)bh * SEQ;
    Seam S;
    if (MODE == 0) moba_select(hd.Q, KSUM + (size_t)((bh >> 3) * 16) * 1024 + (bh & 7) * HD, qb0, qb1, lds);
    else { float* ngl = (float*)(lds + OFF_NG); *(f32x4*)(ngl + tid * 8) = *(const f32x4*)(hd.NG + tid * 8); *(f32x4*)(ngl + tid * 8 + 4) = *(const f32x4*)(hd.NG + tid * 8 + 4); }
    attn_prime<MODE>(hd, qb0 * 256, lds, S);
    for (int pass = 0; pass < 2; ++pass) {
        unsigned selm = 0u;
        if (MODE == 0) selm = ((const unsigned*)(lds + OFF_SEL))[pass * 256 + wave * 32 + (lane & 31)];
        attn_block<MODE>(hd, (pass ? qb1 : qb0) * 256, qb1 * 256, selm, lds, S);
    }
    asm volatile("s_waitcnt vmcnt(0)" ::: "memory");
    __syncthreads();
}
#undef KSWZ
#undef SBAR
}

constexpr size_t MiB = 1u << 20;
constexpr size_t WS_CTL = 0, CTL_ZERO_BYTES = 1 * MiB;
constexpr size_t WS_KSUM = 512 * 1024;
constexpr size_t WS_LOGF = 1 * MiB, WS_NG = WS_LOGF + 256 * 1024, WS_RCOS = WS_NG + 256 * 1024, WS_RSIN = WS_RCOS + 256 * 1024;
constexpr size_t WS_WBR = 3 * MiB, WS_WOUT = 11 * MiB, WS_WUP = 19 * MiB, WS_WDN = 51 * MiB, WS_WIN = 83 * MiB;
constexpr size_t WS_H = 123 * MiB;
constexpr size_t WS_QKV = 155 * MiB;
constexpr size_t WS_SG = 251 * MiB, WS_END = 315 * MiB;
constexpr size_t WS_OCAT = WS_WIN;
constexpr size_t WS_MERGED = WS_QKV, WS_MIXED = WS_QKV + 32 * MiB;
constexpr size_t WS_U = WS_QKV;
constexpr size_t WS_M = WS_WIN;
static_assert(WS_WIN + (size_t)NPROJ * DM * 2 == WS_H && WS_H + (size_t)T * DM * 2 == WS_QKV && WS_QKV + 6ull * T * 1024 * 2 == WS_SG && WS_SG + 2ull * T * DM * 2 == WS_END, "ws map");
static_assert(WS_U + (size_t)T * FF * 2 <= WS_END && WS_M + (size_t)T * DM * 4 <= WS_QKV && WS_MIXED + (size_t)T * DM * 4 <= WS_SG, "ws overlays");
constexpr int CW_BAR = 4096;

constexpr int RING_BYTES = 131072, MISC_OFF = 146432, LDS_BYTES = 147456;
constexpr int P0_SCR_BYTES = 8704, P0_WFF_OFF = 8 * P0_SCR_BYTES;
static_assert(P0_WFF_OFF + 8 * 2048 * 4 <= MISC_OFF && att::LDS_END <= RING_BYTES, "LDS map");

typedef GAS unsigned gu32;
#define RLX_AGENT __ATOMIC_RELAXED, __HIP_MEMORY_SCOPE_AGENT
#define LDS_WAIT() asm volatile("s_waitcnt lgkmcnt(0)" ::: "memory")

#define XB_TMO      128
#define XB_XCNT(j)  (256  + 64 * (j))
#define XB_XSUB(j)  (1280 + 64 * (j))
#define XB_XGEN(j)  (2304 + 64 * (j))
#define XB_TOP      3328
#define XB_TOPGEN   3392
#define XCD_BAR_WORDS 3456
#define XB_SPIN_CAP (1u << 18)
__device__ __forceinline__ unsigned xb_ld(unsigned* p)              { return __hip_atomic_load(p, __ATOMIC_RELAXED, __HIP_MEMORY_SCOPE_AGENT); }
__device__ __forceinline__ unsigned xb_add(unsigned* p, unsigned v) { return __hip_atomic_fetch_add(p, v, __ATOMIC_RELAXED, __HIP_MEMORY_SCOPE_AGENT); }
__device__ __forceinline__ unsigned xb_xcc_id() { return (unsigned)__builtin_amdgcn_s_getreg((3 << 11) | 20) & 0xFu; }
#define XB_SPIN(cond, bar) do { unsigned _sp = 0; while (cond) { __builtin_amdgcn_s_sleep(1); \
    if ((++_sp & 255u) == 0u) { if (xb_ld(&(bar)[XB_TMO])) break; if (_sp > XB_SPIN_CAP) { atomicAdd(&(bar)[XB_TMO], 1u); break; } } } } while (0)
struct XcdBarrier { unsigned* bar; unsigned x; volatile LAS unsigned* st; };
__device__ __forceinline__ XcdBarrier xcd_barrier_post(unsigned* bar, volatile LAS unsigned* st) {
    XcdBarrier b; b.bar = bar; b.x = xb_xcc_id(); b.st = st;
    if (threadIdx.x == 0) (void)xb_add(&bar[XB_XCNT(b.x)], 1u);
    return b;
}
__device__ __forceinline__ void xcd_barrier_complete(unsigned* bar, unsigned x, unsigned& nloc, unsigned& nx) {
    const unsigned G = gridDim.x * gridDim.y * gridDim.z;
    unsigned sum, cnt, mine, sp = 0u;
    for (;;) {
        sum = 0u; cnt = 0u; mine = 0u;
#pragma unroll
        for (unsigned j = 0; j < 16; ++j) { const unsigned c = xb_ld(&bar[XB_XCNT(j)]); sum += c; cnt += (c > 0u) ? 1u : 0u; mine = (j == x) ? c : mine; }
        if (sum == G) break;
        __builtin_amdgcn_s_sleep(1);
        if ((++sp & 255u) == 0u) { if (xb_ld(&bar[XB_TMO])) break; if (sp > XB_SPIN_CAP) { atomicAdd(&bar[XB_TMO], 1u); break; } }
    }
    nloc = mine > 0u ? mine : 1u; nx = cnt > 0u ? cnt : 1u;
}
__device__ __forceinline__ void xcd_barrier(const XcdBarrier& b) {
    asm volatile("s_waitcnt vmcnt(0)" ::: "memory");
    __syncthreads();
    if (threadIdx.x == 0) {
        unsigned* bar = b.bar;
        __builtin_amdgcn_s_waitcnt(0);
        unsigned nloc = b.st[0], nx = b.st[1];
        if (nloc == 0u) { xcd_barrier_complete(bar, b.x, nloc, nx); b.st[0] = nloc; b.st[1] = nx; }
        const unsigned old = xb_add(&bar[XB_XSUB(b.x)], 1u);
        const unsigned gen = old / nloc;
        if (old + 1u == (gen + 1u) * nloc) {
            __builtin_amdgcn_fence(__ATOMIC_RELEASE, "agent");
            asm volatile("s_waitcnt vmcnt(0)" ::: "memory");
            const unsigned og = xb_add(&bar[XB_TOP], 1u);
            const unsigned tg = og / nx;
            if (og + 1u == (tg + 1u) * nx) xb_add(&bar[XB_TOPGEN], 1u);
            else XB_SPIN(xb_ld(&bar[XB_TOPGEN]) == tg, bar);
            __builtin_amdgcn_fence(__ATOMIC_ACQUIRE, "agent");
            xb_add(&bar[XB_XGEN(b.x)], 1u);
            asm volatile("s_waitcnt vmcnt(0)" ::: "memory");
        } else {
            XB_SPIN(xb_ld(&bar[XB_XGEN(b.x)]) == gen, bar);
            __builtin_amdgcn_fence(__ATOMIC_ACQUIRE, "agent");
            asm volatile("s_waitcnt vmcnt(0)" ::: "memory");
        }
    }
    __syncthreads();
}

__device__ __forceinline__ float wave_sum(float v) {
#pragma unroll
    for (int o = 1; o < 64; o <<= 1) v += __shfl_xor(v, o);
    return v;
}
__device__ __forceinline__ float dot4(const f32x4 a, const f32x4 b) { return (a[0] * b[0] + a[1] * b[1]) + (a[2] * b[2] + a[3] * b[3]); }
__device__ __forceinline__ void p0_transpose_item(const float* W, int ldw, int scol, int k0, h16* WT, int ldt, int drow, int dcol, LAS float* scr, int lane) {
#pragma unroll 8
    for (int i = 0; i < 32; ++i) { const int kk = 2 * i + (lane >> 5); scr[kk * 33 + (lane & 31)] = W[(size_t)(k0 + kk) * ldw + scol + (lane & 31)]; }
    LDS_WAIT(); asm volatile("" ::: "memory");
    const int c = lane & 7;
#pragma unroll
    for (int j = 0; j < 4; ++j) { const int n = (lane >> 3) + 8 * j; const LAS float* s = scr + (8 * c) * 33 + n;
        u32x4 o; o.x = pkh(s[0 * 33], s[1 * 33]); o.y = pkh(s[2 * 33], s[3 * 33]); o.z = pkh(s[4 * 33], s[5 * 33]); o.w = pkh(s[6 * 33], s[7 * 33]);
        *(u32x4*)(WT + (size_t)(drow + n) * ldt + dcol + k0 + 8 * c) = o; }
    LDS_WAIT(); asm volatile("" ::: "memory");
}
__device__ __forceinline__ void rope_entry(int s, int i, float& c_out, float& s_out) {
    double f = 1.0; for (int k = 0; k < i; ++k) f *= 0.4403666026717804735919833;
    const double ang = (double)s * f;
    const double q = __builtin_rint(ang * 0.63661977236758134308);
    double y = __builtin_fma(-q, 1.5707963267948966, ang); y = __builtin_fma(-q, 6.123233995736766e-17, y);
    const double y2 = y * y;
    const double sn = y * (1.0 + y2 * (-1.0 / 6 + y2 * (1.0 / 120 + y2 * (-1.0 / 5040 + y2 * (1.0 / 362880 + y2 * (-1.0 / 39916800 + y2 * (1.0 / 6227020800.0)))))));
    const double cs = 1.0 + y2 * (-0.5 + y2 * (1.0 / 24 + y2 * (-1.0 / 720 + y2 * (1.0 / 40320 + y2 * (-1.0 / 3628800 + y2 * (1.0 / 479001600 + y2 * (-1.0 / 87178291200.0)))))));
    const int qi = (int)((long long)q & 3);
    const double cc = (qi == 0) ? cs : (qi == 1) ? -sn : (qi == 2) ? -cs : sn;
    const double ss = (qi == 0) ? sn : (qi == 1) ? cs : (qi == 2) ? -sn : -cs;
    c_out = (float)cc; s_out = (float)ss;
}

struct Args { const float* in[12]; float* out; unsigned char* ws; int ph_lo, ph_hi; };
constexpr int NPHASE = 9;

__global__ void __launch_bounds__(512, 2) hybrid_fwd(Args args) {
    extern __shared__ __attribute__((aligned(16))) unsigned char lds[];
    LAS unsigned char* ldsl = (LAS unsigned char*)lds;
    volatile LAS unsigned* MISC = (volatile LAS unsigned*)(ldsl + MISC_OFF);
    const int tid = threadIdx.x, lane = tid & 63, wave = __builtin_amdgcn_readfirstlane(tid >> 6);
    const int G = gridDim.x, bx = blockIdx.x, vcu = (G % 8 == 0) ? (bx % 8) * (G / 8) + bx / 8 : bx;
    unsigned char* ws = args.ws;
    const float* x = args.in[0]; const float* w_in = args.in[1]; const float* b_forget = args.in[2]; const float* w_bm = args.in[3]; const float* w_bf = args.in[4];
    const float* w_out = args.in[5]; const float* g_mix_pre = args.in[6]; const float* g_mix_post = args.in[7]; const float* w_up = args.in[8]; const float* w_down = args.in[9];
    const float* g_mlp_pre = args.in[10]; const float* g_mlp_post = args.in[11]; float* out = args.out;
    h16* Win_t = (h16*)(ws + WS_WIN); h16* Wbr_t = (h16*)(ws + WS_WBR); h16* Wout_t = (h16*)(ws + WS_WOUT); h16* Wup_t = (h16*)(ws + WS_WUP); h16* Wdn_t = (h16*)(ws + WS_WDN);
    h16* Hb = (h16*)(ws + WS_H); h16* QKV = (h16*)(ws + WS_QKV); h16* SG = (h16*)(ws + WS_SG); h16* OCAT = (h16*)(ws + WS_OCAT); h16* MERGED = (h16*)(ws + WS_MERGED);
    float* MIXED = (float*)(ws + WS_MIXED); h16* U = (h16*)(ws + WS_U); float* MO = (float*)(ws + WS_M);
    float* KSUM = (float*)(ws + WS_KSUM); float* LOGF = (float*)(ws + WS_LOGF); float* NG = (float*)(ws + WS_NG); float* RCOS = (float*)(ws + WS_RCOS); float* RSIN = (float*)(ws + WS_RSIN);
    unsigned* ctl = (unsigned*)(ws + WS_CTL);

    for (int u = tid; u < (LDS_BYTES - MISC_OFF) / 4; u += 512) ((LAS unsigned*)(ldsl + MISC_OFF))[u] = 0u;
    __syncthreads();
    XcdBarrier bar; bar.bar = ctl + CW_BAR; bar.x = 0; bar.st = nullptr;
    if (MK_N_LAUNCHES == 1) bar = xcd_barrier_post(ctl + CW_BAR, MISC + 8);
    const int lo = args.ph_lo, hi = args.ph_hi;
#ifndef PH_MASK
#define PH_MASK 0x1ff
#endif
#define IN(k) (((PH_MASK >> (k)) & 1) && lo <= (k) && (k) < hi)
#define SEAM(k) do { if (IN(k) && IN((k) + 1)) xcd_barrier(bar); } while (0)
    const int gw = vcu * 8 + wave, NGW = G * 8;

    if (IN(0)) {
        {
            const int gt = (bx * 512 + tid);
            for (int e = gt; e < SEQ * 16; e += G * 512) { float c, s; rope_entry(e >> 4, e & 15, c, s); RCOS[e] = c; RSIN[e] = s; }
        }
        LAS float* wff = (LAS float*)(ldsl + P0_WFF_OFF);
        for (int k = tid; k < DM; k += 512) { const f32x4 a = *(const f32x4*)(w_in + (size_t)k * IN_COLS + FF_COL), b = *(const f32x4*)(w_in + (size_t)k * IN_COLS + FF_COL + 4);
            wff[0 * DM + k] = a[0]; wff[1 * DM + k] = a[1]; wff[2 * DM + k] = a[2]; wff[3 * DM + k] = a[3]; wff[4 * DM + k] = b[0]; wff[5 * DM + k] = b[1]; wff[6 * DM + k] = b[2]; wff[7 * DM + k] = b[3]; }
        __syncthreads();
        for (int m = gw; m < T; m += NGW) {
            asm volatile("" ::: "memory");
            const f32x4* xr = (const f32x4*)(x + (size_t)m * DM) + lane; const f32x4* gr = (const f32x4*)g_mix_pre + lane;
            f32x4 v[8]; float ss = 0.f;
#pragma unroll
            for (int j = 0; j < 8; ++j) { v[j] = xr[64 * j]; ss += dot4(v[j], v[j]); }
            const float rstd = 1.0f / sqrtf(wave_sum(ss) * (1.0f / DM) + RMS_EPS);
            float fa[8];
#pragma unroll
            for (int jj = 0; jj < 8; ++jj) fa[jj] = 0.f;
            u32x2* o8 = (u32x2*)(Hb + (size_t)m * DM) + lane;
#pragma unroll
            for (int j = 0; j < 8; ++j) { const f32x4 hv = v[j] * rstd * gr[64 * j];
                u32x2 w; w.x = pkh(hv[0], hv[1]); w.y = pkh(hv[2], hv[3]); o8[64 * j] = w;
#pragma unroll
                for (int jj = 0; jj < 8; ++jj) { const f32x4 wv = *(const LAS f32x4*)(wff + jj * DM + 4 * lane + 256 * j); fa[jj] += dot4(hv, wv); } }
#pragma unroll
            for (int jj = 0; jj < 8; ++jj) fa[jj] = wave_sum(fa[jj]);
            if (lane < 8) { float z = fa[0];
#pragma unroll
                for (int jj = 1; jj < 8; ++jj) z = (lane == jj) ? fa[jj] : z;
                z += b_forget[lane];
                const float lf = fminf(z, 0.f) - log1pf(expf(-fabsf(z)));
                LOGF[(size_t)((m >> 12) * NH + lane) * SEQ + (m & (SEQ - 1))] = lf; }
        }
        __syncthreads();
        LAS float* scr = (LAS float*)(ldsl + wave * P0_SCR_BYTES);
        constexpr int I_IN = (DM / 64) * (NPROJ / 32), I_BR = (1024 / 64) * (DM / 32), I_OUT = (DM / 64) * (DM / 32), I_UP = (DM / 64) * (FF / 32), I_DN = (FF / 64) * (DM / 32);
        constexpr int NITEMS = I_IN + 2 * I_BR + I_OUT + I_UP + I_DN;
        for (int it = gw; it < NITEMS; it += NGW) {
            int r = it;
            if (r < I_IN) { const int nb = r % (NPROJ / 32), kb = r / (NPROJ / 32), n0 = 32 * nb; p0_transpose_item(w_in, IN_COLS, n0 < FF_COL ? n0 : n0 + 8, 64 * kb, Win_t, DM, n0, 0, scr, lane); continue; } r -= I_IN;
            if (r < I_BR) { const int nb = r % (DM / 32), kb = r / (DM / 32); p0_transpose_item(w_bm, DM, 32 * nb, 64 * kb, Wbr_t, DM, 32 * nb, 0, scr, lane); continue; } r -= I_BR;
            if (r < I_BR) { const int nb = r % (DM / 32), kb = r / (DM / 32); p0_transpose_item(w_bf, DM, 32 * nb, 64 * kb, Wbr_t, DM, 32 * nb, 1024, scr, lane); continue; } r -= I_BR;
            if (r < I_OUT) { const int nb = r % (DM / 32), kb = r / (DM / 32); p0_transpose_item(w_out, DM, 32 * nb, 64 * kb, Wout_t, DM, 32 * nb, 0, scr, lane); continue; } r -= I_OUT;
            if (r < I_UP) { const int nb = r % (FF / 32), kb = r / (FF / 32); p0_transpose_item(w_up, FF, 32 * nb, 64 * kb, Wup_t, DM, 32 * nb, 0, scr, lane); continue; } r -= I_UP;
            { const int nb = r % (DM / 32), kb = r / (DM / 32); p0_transpose_item(w_down, DM, 32 * nb, 64 * kb, Wdn_t, FF, 32 * nb, 0, scr, lane); }
        }
    }
    SEAM(0);

    if (IN(1)) {
        if (bx < 16) {
            const float* lf = LOGF + (size_t)bx * SEQ; float* ng = NG + (size_t)bx * SEQ;
            const f32x4 a = *(const f32x4*)(lf + tid * 8), b = *(const f32x4*)(lf + tid * 8 + 4);
            float p[8]; p[0] = a[0]; p[1] = p[0] + a[1]; p[2] = p[1] + a[2]; p[3] = p[2] + a[3]; p[4] = p[3] + b[0]; p[5] = p[4] + b[1]; p[6] = p[5] + b[2]; p[7] = p[6] + b[3];
            const float tot = p[7]; float sc = tot;
#pragma unroll
            for (int o = 1; o < 64; o <<= 1) { const float v = __shfl_up(sc, o); if (lane >= o) sc += v; }
            LAS float* wt = (LAS float*)ldsl;
            if (lane == 63) wt[wave] = sc;
            __syncthreads();
            float basev = 0.f;
            for (int w = 0; w < wave; ++w) basev += wt[w];
            const float excl = basev + sc - tot;
            f32x4 o0, o1;
            o0[0] = -(excl + p[0]) * LOG2E; o0[1] = -(excl + p[1]) * LOG2E; o0[2] = -(excl + p[2]) * LOG2E; o0[3] = -(excl + p[3]) * LOG2E;
            o1[0] = -(excl + p[4]) * LOG2E; o1[1] = -(excl + p[5]) * LOG2E; o1[2] = -(excl + p[6]) * LOG2E; o1[3] = -(excl + p[7]) * LOG2E;
            *(f32x4*)(ng + tid * 8) = o0; *(f32x4*)(ng + tid * 8 + 4) = o1;
            __syncthreads();
        }
        pg8::Gemm g{Hb, Win_t, DM, DM, DM}; pg8::StaticOrder S; S.init(T, NPROJ, G, bx);
        pg8::EpiProj E{QKV, SG, KSUM, RCOS, RSIN};
        pg8::gemm_phase<pg8::EpiProj, pg8::StaticOrder, true>(ldsl, g, S, E);
    }
    SEAM(1);

    if (IN(2)) {
        const int item = vcu;
        if (item < 128) att::attn_item<0>(item, QKV, OCAT, KSUM, NG, (char*)lds);
        else if (item < 256) att::attn_item<1>(item, QKV, OCAT, KSUM, NG, (char*)lds);
    }
    SEAM(2);

    if (IN(3)) {
        pg8::Gemm g{OCAT, Wbr_t, DM, DM, 1024}; pg8::TwoPassOrder S; S.so.init(T, DM, G, bx);
        pg8::EpiMerge E{SG, SG + (size_t)T * DM, MERGED};
        pg8::gemm_phase<pg8::EpiMerge, pg8::TwoPassOrder, false>(ldsl, g, S, E);
    }
    SEAM(3);

    if (IN(4)) {
        pg8::Gemm g{MERGED, Wout_t, DM, DM, DM}; pg8::StaticOrder S; S.init(T, DM, G, bx);
        pg8::EpiF32 E{MIXED, DM};
        pg8::gemm_phase<pg8::EpiF32, pg8::StaticOrder, false>(ldsl, g, S, E);
    }
    SEAM(4);

    if (IN(5)) {
        for (int m = gw; m < T; m += NGW) {
            const f32x4* mr = (const f32x4*)(MIXED + (size_t)m * DM) + lane; const f32x4* xr = (const f32x4*)(x + (size_t)m * DM) + lane;
            const f32x4* g1 = (const f32x4*)g_mix_post + lane; const f32x4* g2 = (const f32x4*)g_mlp_pre + lane;
            f32x4 v[8]; float ss = 0.f;
#pragma unroll
            for (int j = 0; j < 8; ++j) { v[j] = mr[64 * j]; ss += dot4(v[j], v[j]); }
            const float r1 = 1.0f / sqrtf(wave_sum(ss) * (1.0f / DM) + RMS_EPS);
            float ss2 = 0.f; f32x4* orow = (f32x4*)(out + (size_t)m * DM) + lane;
#pragma unroll
            for (int j = 0; j < 8; ++j) { v[j] = xr[64 * j] + v[j] * r1 * g1[64 * j]; orow[64 * j] = v[j]; ss2 += dot4(v[j], v[j]); }
            const float r2 = 1.0f / sqrtf(wave_sum(ss2) * (1.0f / DM) + RMS_EPS);
            u32x2* o8 = (u32x2*)(Hb + (size_t)m * DM) + lane;
#pragma unroll
            for (int j = 0; j < 8; ++j) { const f32x4 hv = v[j] * r2 * g2[64 * j]; u32x2 w; w.x = pkh(hv[0], hv[1]); w.y = pkh(hv[2], hv[3]); o8[64 * j] = w; }
        }
    }
    SEAM(5);

    if (IN(6)) {
        pg8::Gemm g{Hb, Wup_t, DM, DM, DM}; pg8::StaticOrder S; S.init(T, FF, G, bx);
        pg8::EpiRelu2 E{U, FF};
        pg8::gemm_phase<pg8::EpiRelu2, pg8::StaticOrder, true>(ldsl, g, S, E);
    }
    SEAM(6);

    if (IN(7)) {
        pg8::Gemm g{U, Wdn_t, FF, FF, FF}; pg8::StaticOrder S; S.init(T, DM, G, bx);
        pg8::EpiF32 E{MO, DM};
        pg8::gemm_phase<pg8::EpiF32, pg8::StaticOrder, false>(ldsl, g, S, E);
    }
    SEAM(7);

    if (IN(8)) {
        for (int m = gw; m < T; m += NGW) {
            const f32x4* mr = (const f32x4*)(MO + (size_t)m * DM) + lane; const f32x4* g1 = (const f32x4*)g_mlp_post + lane;
            f32x4* orow = (f32x4*)(out + (size_t)m * DM) + lane;
            f32x4 v[8]; float ss = 0.f;
#pragma unroll
            for (int j = 0; j < 8; ++j) { v[j] = mr[64 * j]; ss += dot4(v[j], v[j]); }
            const float r1 = 1.0f / sqrtf(wave_sum(ss) * (1.0f / DM) + RMS_EPS);
#pragma unroll
            for (int j = 0; j < 8; ++j) orow[64 * j] = orow[64 * j] + v[j] * r1 * g1[64 * j];
        }
    }
#undef IN
#undef SEAM
}

extern "C" void kernel_launch(void* const* d_in, const int* in_sizes, int n_in, void* d_out, int out_size, void* d_ws, size_t ws_size, hipStream_t stream) {
    static int grid = 0;
    if (grid == 0) {
        if (n_in != 12 || in_sizes[0] != T * DM || out_size != T * DM || ws_size < WS_END) { fprintf(stderr, "kernel_launch: unexpected shapes (n_in %d, in0 %d, out %d, ws %zu < %zu)\n", n_in, n_in > 0 ? in_sizes[0] : -1, out_size, ws_size, (size_t)WS_END); grid = -1; return; }
        int dev = 0, cus = 0, per_cu = 0;
        if (hipGetDevice(&dev) != hipSuccess || hipDeviceGetAttribute(&cus, hipDeviceAttributeMultiprocessorCount, dev) != hipSuccess) { grid = -1; return; }
        if (hipFuncSetAttribute((const void*)hybrid_fwd, hipFuncAttributeMaxDynamicSharedMemorySize, LDS_BYTES) != hipSuccess) { fprintf(stderr, "kernel_launch: hipFuncSetAttribute failed\n"); grid = -1; return; }
        if (hipOccupancyMaxActiveBlocksPerMultiprocessor(&per_cu, (const void*)hybrid_fwd, 512, LDS_BYTES) != hipSuccess || per_cu < 1) { fprintf(stderr, "kernel_launch: occupancy query says %d blocks per CU\n", per_cu); per_cu = 1; }
        (void)hipGetLastError();
        grid = cus;
        if (grid > 256) grid = 256;
    }
    if (grid < 0) return;
    if (hipMemsetAsync((char*)d_ws + WS_CTL, 0, CTL_ZERO_BYTES, stream) != hipSuccess) { fprintf(stderr, "kernel_launch: memset failed\n"); return; }
    Args a{};
    for (int i = 0; i < 12; ++i) a.in[i] = (const float*)d_in[i];
    a.out = (float*)d_out; a.ws = (unsigned char*)d_ws;
    const int nl = MK_N_LAUNCHES == 1 ? 1 : NPHASE;
    for (int li = 0; li < nl; ++li) {
        a.ph_lo = (nl == 1) ? 0 : li; a.ph_hi = (nl == 1) ? NPHASE : li + 1;
        hipLaunchKernelGGL(hybrid_fwd, dim3(grid), dim3(512), LDS_BYTES, stream, a);
        const hipError_t le = hipPeekAtLastError();
        if (le != hipSuccess) { fprintf(stderr, "kernel_launch: launch %d failed: %s\n", li, hipGetErrorName(le)); break; }
    }
}
```
